# Optimizing an MI355X kernel written in HIP

```python
import math
import jax, jax.numpy as jnp
from jax import lax
import numpy as np

D_MODEL = 1024
BATCH = 4
SEQ = 4096
DEPTH = 2

CHUNK = 64
DN_HEADS = 8
DN_HEAD_DIM = 128
DN_WIDTH = DN_HEADS * DN_HEAD_DIM
CONV_WIDTH = 4
AT_HEADS = 8
AT_HEAD_DIM = 64
AT_WIDTH = AT_HEADS * AT_HEAD_DIM
LEFT_CHUNKS = 8
BAND = LEFT_CHUNKS + 1
REL_CLIP = 256
N_EXPERTS = 64
TOP_K = 6
EXPERT_DIM = 256
SHARED_DIM = 256
ROUTED_SCALE = 2.5
MOE_BLOCK = 128
ALPHA = (2 * DEPTH) ** 0.25
BETA_INIT = (8 * DEPTH) ** -0.25
LN_EPS = 1e-5
RMS_EPS = 1e-6
L2_EPS = 1e-6
NEG_INF = -1e30

_IN_SPLITS = (DN_WIDTH, DN_WIDTH, DN_WIDTH, DN_WIDTH, DN_HEADS, DN_HEADS,
              AT_WIDTH, AT_WIDTH, AT_WIDTH, D_MODEL, D_MODEL)
IN_COLS = sum(_IN_SPLITS)
SPLIT_POINTS = tuple(int(v) for v in np.cumsum(_IN_SPLITS)[:-1])

kernel_name = "hybrid_deltanet_chunkattn_moe_deepnorm"


def layer_norm(x, g, b):
    xf = x.astype(jnp.float32)
    mu = jnp.mean(xf, axis=-1, keepdims=True)
    var = jnp.mean(jnp.square(xf - mu), axis=-1, keepdims=True)
    y = (xf - mu) * lax.rsqrt(var + LN_EPS) * g.astype(jnp.float32) + b.astype(jnp.float32)
    return y.astype(x.dtype)


def causal_depthwise_conv(x, w):
    T = x.shape[1]
    xp = jnp.pad(x, ((0, 0), (CONV_WIDTH - 1, 0), (0, 0)))
    return sum(xp[:, i:i + T] * w[i] for i in range(CONV_WIDTH))


def l2_normalize(x):
    return x * lax.rsqrt(jnp.sum(jnp.square(x), axis=-1, keepdims=True) + L2_EPS)


def delta_rule_chunked(q, k, v, g, beta):
    B, T, H, dk = q.shape
    dv = v.shape[-1]
    nc = T // CHUNK

    def chunks(a):
        return jnp.moveaxis(a.reshape(B, nc, CHUNK, H, -1), 3, 1)

    q, k, v = chunks(q), chunks(k), chunks(v)
    g = jnp.moveaxis(g.reshape(B, nc, CHUNK, H), 3, 1)
    beta = jnp.moveaxis(beta.reshape(B, nc, CHUNK, H), 3, 1)
    gc = jnp.cumsum(g, axis=-1)
    pos = jnp.arange(CHUNK)
    incl = pos[:, None] >= pos[None, :]
    strict = pos[:, None] > pos[None, :]
    decay = jnp.exp(jnp.where(incl, gc[..., :, None] - gc[..., None, :], -jnp.inf))

    kb = k * beta[..., None]
    lower = jnp.where(strict, jnp.einsum('bhnid,bhnjd->bhnij', kb, k) * decay, 0.0)
    eye = jnp.broadcast_to(jnp.eye(CHUNK, dtype=lower.dtype), lower.shape)
    t_inv = lax.linalg.triangular_solve(eye + lower, eye, left_side=True, lower=True,
                                        unit_diagonal=True)
    w = t_inv @ (kb * jnp.exp(gc)[..., None])
    u = t_inv @ (v * beta[..., None])
    qk = jnp.einsum('bhnid,bhnjd->bhnij', q, k) * decay
    q_dec = q * jnp.exp(gc)[..., None]
    k_dec = k * jnp.exp(gc[..., -1:] - gc)[..., None]
    chunk_decay = jnp.exp(gc[..., -1])

    xs = tuple(jnp.moveaxis(a, 2, 0) for a in (u, w, q_dec, qk, k_dec, chunk_decay))

    def step(S, inp):
        u_n, w_n, qd_n, qk_n, kd_n, dec_n = inp
        v_new = u_n - w_n @ S
        o_n = qd_n @ S + qk_n @ v_new
        S = S * dec_n[..., None, None] + jnp.swapaxes(kd_n, -1, -2) @ v_new
        return S, o_n

    S0 = jnp.zeros((B, H, dk, dv), jnp.float32)
    _, o = lax.scan(step, S0, xs)
    return o.transpose(1, 0, 3, 2, 4).reshape(B, T, H, dv)


def gated_deltanet(q_in, k_in, v_in, z, b_in, a_in, conv_w, a_log, dt_bias, norm_w):
    B, T, _ = q_in.shape
    qkv = jax.nn.silu(causal_depthwise_conv(jnp.concatenate([q_in, k_in, v_in], axis=-1), conv_w))
    qkv = qkv.astype(jnp.float32).reshape(B, T, 3, DN_HEADS, DN_HEAD_DIM)
    q = l2_normalize(qkv[:, :, 0]) * (DN_HEAD_DIM ** -0.5)
    k = l2_normalize(qkv[:, :, 1])
    v = qkv[:, :, 2]
    beta = jax.nn.sigmoid(b_in.astype(jnp.float32))
    g = -jnp.exp(a_log.astype(jnp.float32)) * jax.nn.softplus(a_in.astype(jnp.float32)
                                                              + dt_bias.astype(jnp.float32))
    o = delta_rule_chunked(q, k, v, g, beta)
    o = o * lax.rsqrt(jnp.mean(jnp.square(o), axis=-1, keepdims=True) + RMS_EPS)
    o = o * norm_w.astype(jnp.float32) * jax.nn.silu(z.astype(jnp.float32).reshape(o.shape))
    return o.reshape(B, T, DN_WIDTH).astype(q_in.dtype)


def chunk_band_attention(q_in, k_in, v_in, rel_table):
    B, T, _ = q_in.shape
    nc = T // CHUNK
    q = q_in.reshape(B, nc, CHUNK, AT_HEADS, AT_HEAD_DIM)
    pad = ((0, 0), (LEFT_CHUNKS, 0), (0, 0), (0, 0), (0, 0))
    k = jnp.pad(k_in.reshape(B, nc, CHUNK, AT_HEADS, AT_HEAD_DIM), pad)
    v = jnp.pad(v_in.reshape(B, nc, CHUNK, AT_HEADS, AT_HEAD_DIM), pad)
    band_idx = jnp.arange(nc)[:, None] + jnp.arange(BAND)[None, :]
    kb = k[:, band_idx].reshape(B, nc, BAND * CHUNK, AT_HEADS, AT_HEAD_DIM)
    vb = v[:, band_idx].reshape(B, nc, BAND * CHUNK, AT_HEADS, AT_HEAD_DIM)
    scores = jnp.einsum('bnqhd,bnkhd->bhnqk', q, kb).astype(jnp.float32) * (AT_HEAD_DIM ** -0.5)
    q_pos = jnp.arange(CHUNK)
    k_pos = jnp.arange(BAND * CHUNK) - LEFT_CHUNKS * CHUNK
    rel = jnp.clip(k_pos[None, :] - q_pos[:, None], -REL_CLIP, REL_CLIP) + REL_CLIP
    bias = rel_table.astype(jnp.float32)[:, rel]
    key_valid = jnp.repeat(band_idx >= LEFT_CHUNKS, CHUNK, axis=1)
    scores = jnp.where(key_valid[None, None, :, None, :], scores + bias[None, :, None], NEG_INF)
    p = jax.nn.softmax(scores, axis=-1).astype(vb.dtype)
    o = jnp.einsum('bhnqk,bnkhd->bnqhd', p, vb)
    return o.reshape(B, T, AT_WIDTH)


def moe_ffn(x, router_w, router_bias, w_gate_up, w_down, ws_gate_up, ws_down):
    B, T, D = x.shape
    N = B * T
    xt = x.reshape(N, D)
    scores = jax.nn.sigmoid((xt @ router_w).astype(jnp.float32))
    _, sel = lax.top_k(scores + router_bias.astype(jnp.float32), TOP_K)
    wsel = jnp.take_along_axis(scores, sel, axis=-1)
    wsel = wsel / jnp.sum(wsel, axis=-1, keepdims=True) * ROUTED_SCALE

    nk = N * TOP_K
    flat_e = sel.reshape(nk)
    flat_t = jnp.repeat(jnp.arange(N, dtype=jnp.int32), TOP_K)
    flat_w = wsel.reshape(nk)
    order = jnp.argsort(flat_e)
    e_s, t_s, w_s = flat_e[order], flat_t[order], flat_w[order]
    counts = jnp.bincount(flat_e, length=N_EXPERTS)
    start = jnp.cumsum(counts) - counts
    padded = (counts + MOE_BLOCK - 1) // MOE_BLOCK * MOE_BLOCK
    pend = jnp.cumsum(padded)
    pstart = pend - padded
    dest = pstart[e_s] + (jnp.arange(nk) - start[e_s])
    n_blocks = -(-(nk + N_EXPERTS * (MOE_BLOCK - 1)) // MOE_BLOCK)
    n_rows = n_blocks * MOE_BLOCK
    row_tok = jnp.full((n_rows,), N, jnp.int32).at[dest].set(t_s)
    row_w = jnp.zeros((n_rows,), jnp.float32).at[dest].set(w_s)
    blk_e = jnp.minimum(jnp.searchsorted(pend, jnp.arange(n_blocks) * MOE_BLOCK, side='right'),
                        N_EXPERTS - 1)
    x_pad = jnp.concatenate([xt, jnp.zeros((1, D), xt.dtype)], axis=0)

    def block_fn(args):
        tok, wt, e = args
        gu = x_pad[tok] @ w_gate_up[e]
        h = jax.nn.silu(gu[:, :EXPERT_DIM]) * gu[:, EXPERT_DIM:]
        return (h @ w_down[e]) * wt[:, None]

    y_rows = lax.map(block_fn, (row_tok.reshape(n_blocks, MOE_BLOCK),
                                row_w.reshape(n_blocks, MOE_BLOCK), blk_e))
    routed = jax.ops.segment_sum(y_rows.reshape(n_rows, D), row_tok, num_segments=N + 1)[:N]
    gus = xt @ ws_gate_up
    shared = (jax.nn.silu(gus[:, :SHARED_DIM]) * gus[:, SHARED_DIM:]) @ ws_down
    return (routed.astype(x.dtype) + shared).reshape(B, T, D)


def setup_inputs(seed: int = 0) -> dict:
    key = jax.random.key(seed)
    ks = jax.random.split(key, 24)
    L, D = DEPTH, D_MODEL
    nrm = jax.random.normal
    dt = jnp.exp(jax.random.uniform(ks[4], (L, DN_HEADS)) * (math.log(0.1) - math.log(0.001))
                 + math.log(0.001))
    return {
        'x': nrm(ks[0], (BATCH, SEQ, D), jnp.float32),
        'w_in': nrm(ks[1], (L, D, IN_COLS), jnp.float32) * D ** -0.5,
        'conv_w': nrm(ks[2], (L, CONV_WIDTH, 3 * DN_WIDTH), jnp.float32) * CONV_WIDTH ** -0.5,
        'a_log': jnp.log(jax.random.uniform(ks[3], (L, DN_HEADS), jnp.float32, 1.0, 16.0)),
        'dt_bias': dt + jnp.log(-jnp.expm1(-dt)),
        'dn_norm_w': 1.0 + 0.02 * nrm(ks[5], (L, DN_HEAD_DIM), jnp.float32),
        'rel_table': 0.5 * nrm(ks[6], (L, AT_HEADS, 2 * REL_CLIP + 1), jnp.float32),
        'w_branch_a': nrm(ks[7], (L, DN_WIDTH, D), jnp.float32) * DN_WIDTH ** -0.5,
        'w_branch_b': nrm(ks[8], (L, AT_WIDTH, D), jnp.float32) * AT_WIDTH ** -0.5,
        'w_out': nrm(ks[9], (L, D, D), jnp.float32) * D ** -0.5 * BETA_INIT,
        'ln1_g': 1.0 + 0.02 * nrm(ks[10], (L, D), jnp.float32),
        'ln1_b': 0.02 * nrm(ks[11], (L, D), jnp.float32),
        'router_w': nrm(ks[12], (L, D, N_EXPERTS), jnp.float32) * D ** -0.5,
        'router_bias': 0.01 * nrm(ks[13], (L, N_EXPERTS), jnp.float32),
        'expert_w_gate_up': nrm(ks[14], (L, N_EXPERTS, D, 2 * EXPERT_DIM), jnp.float32) * D ** -0.5,
        'expert_w_down': nrm(ks[15], (L, N_EXPERTS, EXPERT_DIM, D), jnp.float32)
                         * EXPERT_DIM ** -0.5 * BETA_INIT,
        'shared_w_gate_up': nrm(ks[16], (L, D, 2 * SHARED_DIM), jnp.float32) * D ** -0.5,
        'shared_w_down': nrm(ks[17], (L, SHARED_DIM, D), jnp.float32) * SHARED_DIM ** -0.5 * BETA_INIT,
        'ln2_g': 1.0 + 0.02 * nrm(ks[18], (L, D), jnp.float32),
        'ln2_b': 0.02 * nrm(ks[19], (L, D), jnp.float32),
    }


def reference(x, w_in, conv_w, a_log, dt_bias, dn_norm_w, rel_table, w_branch_a, w_branch_b,
              w_out, ln1_g, ln1_b, router_w, router_bias, expert_w_gate_up, expert_w_down,
              shared_w_gate_up, shared_w_down, ln2_g, ln2_b):
    for l in range(DEPTH):
        proj = x @ w_in[l]
        dq, dk, dv, dz, db, da, aq, ak, av, ga, gb = jnp.split(proj, SPLIT_POINTS, axis=-1)
        ya = gated_deltanet(dq, dk, dv, dz, db, da, conv_w[l], a_log[l], dt_bias[l],
                            dn_norm_w[l]) @ w_branch_a[l]
        yb = chunk_band_attention(aq, ak, av, rel_table[l]) @ w_branch_b[l]
        mix = (jax.nn.sigmoid(ga) * ya + jax.nn.sigmoid(gb) * yb) @ w_out[l]
        x = layer_norm(ALPHA * x + mix, ln1_g[l], ln1_b[l])
        ffn = moe_ffn(x, router_w[l], router_bias[l], expert_w_gate_up[l], expert_w_down[l],
                      shared_w_gate_up[l], shared_w_down[l])
        x = layer_norm(ALPHA * x + ffn, ln2_g[l], ln2_b[l])
    return x
```

```cpp
#include <hip/hip_runtime.h>
#include <cstdio>
#include <cstdint>

constexpr int D = 1024, BATCH = 4, SEQ = 4096, M = BATCH * SEQ, DEPTH = 2;
constexpr int CH = 64, NCH = SEQ / CH;
constexpr int DNH = 8, DNHD = 128;
constexpr int ATH = 8, ATD = 64, ATW = 512;
constexpr int NE = 64, TOPK = 6, EDIM = 256, NEX = NE + 1;
constexpr int INCOLS = 7696, NP = 7936;
constexpr int PC_DQ = 0, PC_DK = 1024, PC_DV = 2048, PC_DZ = 3072, PC_AQ = 4096, PC_AK = 4608, PC_AV = 5120, PC_GA = 5632, PC_GB = 6656, PC_DB = 7680, PC_DA = 7688;
constexpr float ALPHA = 1.41421356237f, LN_EPS = 1e-5f, RMS_EPS = 1e-6f, L2_EPS = 1e-6f, ROUTED_SCALE = 2.5f;

constexpr size_t MiB = 1u << 20;
constexpr size_t WS_CTL = 0, CTL_ZERO_BYTES = 1 * MiB;
constexpr size_t WS_WIN = 2 * MiB;
constexpr size_t WS_WBA = 34 * MiB;
constexpr size_t WS_WBB = 38 * MiB;
constexpr size_t WS_WO = 40 * MiB;
constexpr size_t WS_RW = 44 * MiB;
constexpr size_t WS_WGU = 46 * MiB;
constexpr size_t WS_WD = 176 * MiB;
constexpr size_t WS_XB = 242 * MiB;
constexpr size_t WS_XF = 274 * MiB;
constexpr size_t WS_X1F = 338 * MiB;
constexpr size_t WS_X1B = 402 * MiB;
constexpr size_t WS_PROJ = 434 * MiB;
constexpr size_t WS_DNO = 682 * MiB;
constexpr size_t WS_ATO = 714 * MiB;
constexpr size_t WS_MIXIN = 730 * MiB;
constexpr size_t WS_SEL = 762 * MiB;
constexpr size_t WS_SCR = 764 * MiB;
constexpr size_t WS_BG = 1020 * MiB;
constexpr size_t WS_END = 1021 * MiB;

constexpr int CW_BAR = 4096;

constexpr int RING_BYTES = 131072;
constexpr int MISC_OFF = RING_BYTES;
constexpr int LDS_BYTES = 147456;
constexpr int NWAVES = 8, NTHR = 512;

#define GAS __attribute__((address_space(1)))
#define LAS __attribute__((address_space(3)))
typedef unsigned short bf16;
typedef unsigned v4u __attribute__((ext_vector_type(4)));
typedef unsigned v2u __attribute__((ext_vector_type(2)));
typedef float f32x4 __attribute__((ext_vector_type(4)));
#define LDS_WAIT() asm volatile("s_waitcnt lgkmcnt(0)" ::: "memory")
#define VM_WAIT() asm volatile("s_waitcnt vmcnt(0)" ::: "memory")

__device__ __forceinline__ unsigned f2bf(float f) { unsigned u = __builtin_bit_cast(unsigned, f); return (u + 0x7fffu + ((u >> 16) & 1u)) >> 16; }
__device__ __forceinline__ unsigned pk2(float lo, float hi) { return f2bf(lo) | (f2bf(hi) << 16); }
__device__ __forceinline__ float bf2f(unsigned short b) { return __builtin_bit_cast(float, (unsigned)b << 16); }
__device__ __forceinline__ float bflo(unsigned w) { return __builtin_bit_cast(float, w << 16); }
__device__ __forceinline__ float bfhi(unsigned w) { return __builtin_bit_cast(float, w & 0xffff0000u); }
__device__ __forceinline__ float sigmoidf_(float x) { return 1.f / (1.f + __expf(-x)); }
__device__ __forceinline__ float siluf_(float x) { return x / (1.f + __expf(-x)); }
__device__ __forceinline__ float wave_sum(float v) {
#pragma unroll
    for (int o = 1; o < 64; o <<= 1) v += __shfl_xor(v, o);
    return v;
}
__device__ __forceinline__ float wave_max(float v) {
#pragma unroll
    for (int o = 1; o < 64; o <<= 1) v = fmaxf(v, __shfl_xor(v, o));
    return v;
}

#define XB_TMO      128
#define XB_XCNT(j)  (256  + 64 * (j))
#define XB_XSUB(j)  (1280 + 64 * (j))
#define XB_XGEN(j)  (2304 + 64 * (j))
#define XB_TOP      3328
#define XB_TOPGEN   3392
#define XCD_BAR_WORDS 3456
#define XB_SPIN_CAP (1u << 22)
__device__ __forceinline__ unsigned xb_ld(unsigned* p)              { return __hip_atomic_load(p, __ATOMIC_RELAXED, __HIP_MEMORY_SCOPE_AGENT); }
__device__ __forceinline__ unsigned xb_add(unsigned* p, unsigned v) { return __hip_atomic_fetch_add(p, v, __ATOMIC_RELAXED, __HIP_MEMORY_SCOPE_AGENT); }
__device__ __forceinline__ unsigned xb_xcc_id() { return (unsigned)__builtin_amdgcn_s_getreg((3 << 11) | 20) & 0xFu; }
#define XB_SPIN(cond, bar) do { unsigned _sp = 0; while (cond) { __builtin_amdgcn_s_sleep(1); \
    if ((++_sp & 255u) == 0u) { if (xb_ld(&(bar)[XB_TMO])) break; if (_sp > XB_SPIN_CAP) { atomicAdd(&(bar)[XB_TMO], 1u); break; } } } } while (0)
struct XcdBarrier { unsigned* bar; unsigned x; volatile LAS unsigned* st; };
__device__ __forceinline__ XcdBarrier xcd_barrier_post(unsigned* bar, volatile LAS unsigned* st) {
    XcdBarrier b; b.bar = bar; b.x = xb_xcc_id(); b.st = st;
    if (threadIdx.x == 0) (void)xb_add(&bar[XB_XCNT(b.x)], 1u);
    return b;
}
__device__ __forceinline__ void xcd_barrier_complete(unsigned* bar, unsigned x, unsigned& nloc, unsigned& nx) {
    const unsigned G = gridDim.x * gridDim.y * gridDim.z;
    unsigned sum, cnt, mine, sp = 0u;
    for (;;) {
        sum = 0u; cnt = 0u; mine = 0u;
#pragma unroll
        for (unsigned j = 0; j < 16; ++j) { const unsigned c = xb_ld(&bar[XB_XCNT(j)]); sum += c; cnt += (c > 0u) ? 1u : 0u; mine = (j == x) ? c : mine; }
        if (sum == G) break;
        __builtin_amdgcn_s_sleep(1);
        if ((++sp & 255u) == 0u) { if (xb_ld(&bar[XB_TMO])) break; if (sp > XB_SPIN_CAP) { atomicAdd(&bar[XB_TMO], 1u); break; } }
    }
    nloc = mine > 0u ? mine : 1u; nx = cnt > 0u ? cnt : 1u;
}
__device__ __forceinline__ void xcd_barrier(const XcdBarrier& b) {
    asm volatile("s_waitcnt vmcnt(0)" ::: "memory");
    __syncthreads();
    if (threadIdx.x == 0) {
        unsigned* bar = b.bar;
        __builtin_amdgcn_s_waitcnt(0);
        unsigned nloc = b.st[0], nx = b.st[1];
        if (nloc == 0u) { xcd_barrier_complete(bar, b.x, nloc, nx); b.st[0] = nloc; b.st[1] = nx; }
        const unsigned old = xb_add(&bar[XB_XSUB(b.x)], 1u);
        const unsigned gen = old / nloc;
        if (old + 1u == (gen + 1u) * nloc) {
            __builtin_amdgcn_fence(__ATOMIC_RELEASE, "agent");
            asm volatile("s_waitcnt vmcnt(0)" ::: "memory");
            const unsigned og = xb_add(&bar[XB_TOP], 1u);
            const unsigned tg = og / nx;
            if (og + 1u == (tg + 1u) * nx) xb_add(&bar[XB_TOPGEN], 1u);
            else XB_SPIN(xb_ld(&bar[XB_TOPGEN]) == tg, bar);
            __builtin_amdgcn_fence(__ATOMIC_ACQUIRE, "agent");
            xb_add(&bar[XB_XGEN(b.x)], 1u);
            asm volatile("s_waitcnt vmcnt(0)" ::: "memory");
        } else {
            XB_SPIN(xb_ld(&bar[XB_XGEN(b.x)]) == gen, bar);
            __builtin_amdgcn_fence(__ATOMIC_ACQUIRE, "agent");
            asm volatile("s_waitcnt vmcnt(0)" ::: "memory");
        }
    }
    __syncthreads();
}

struct Args { const float* in[20]; float* out; unsigned char* ws; };
struct Frame {
    unsigned char* lds;
    int tid, lane, wave, G, bid;
    unsigned char* ws;
};

template <int KIND> __device__ __forceinline__ int colmap(int r) {
    if (KIND == 0) return r;
    if (KIND == 1) return r < 4096 ? r : (r < 7680 ? r + 16 : (r < 7696 ? r - 7680 + 4096 : -1));
    const int pn = r >> 8, rr = r & 255; return rr < 128 ? 128 * pn + rr : 256 + 128 * pn + (rr - 128);
}
template <int KIND>
__device__ __forceinline__ void conv_T(const Frame& F, const float* src, size_t src_ms, int K, int ldsrc, bf16* dst, size_t dst_ms, int Ndst, int nmat) {
    float* scr = (float*)(F.lds + F.wave * 16384);
    const int gw = F.bid * NWAVES + F.wave, NGW = F.G * NWAVES, lane = F.lane;
    const int nblk = Ndst / 32, ipm = (K / 64) * nblk, total = ipm * nmat;
    for (int it = gw; it < total; it += NGW) {
        const int mat = it / ipm, sub = it - mat * ipm, kb = sub / nblk, nb = sub - kb * nblk, k0 = 64 * kb, n0 = 32 * nb;
        const float* W = src + (size_t)mat * src_ms; bf16* WT = dst + (size_t)mat * dst_ms;
        const int sc = colmap<KIND>(n0 + (lane & 31));
#pragma unroll 8
        for (int i = 0; i < 32; ++i) { const int kk = 2 * i + (lane >> 5); scr[kk * 33 + (lane & 31)] = sc >= 0 ? W[(size_t)(k0 + kk) * ldsrc + sc] : 0.f; }
        LDS_WAIT(); asm volatile("" ::: "memory");
        const int c = lane & 7;
#pragma unroll
        for (int j = 0; j < 4; ++j) { const int n = (lane >> 3) + 8 * j; const float* s = scr + (8 * c) * 33 + n;
            v4u o; o.x = pk2(s[0 * 33], s[1 * 33]); o.y = pk2(s[2 * 33], s[3 * 33]); o.z = pk2(s[4 * 33], s[5 * 33]); o.w = pk2(s[6 * 33], s[7 * 33]);
            *(v4u*)(WT + (size_t)(n0 + n) * K + k0 + 8 * c) = o; }
        LDS_WAIT(); asm volatile("" ::: "memory");
    }
}
__device__ __forceinline__ void phase_convert(const Frame& F, const Args& a) {
    unsigned char* ws = F.ws;
    conv_T<1>(F, a.in[1], (size_t)D * INCOLS, D, INCOLS, (bf16*)(ws + WS_WIN), (size_t)NP * D, NP, 2);
    conv_T<0>(F, a.in[7], (size_t)D * D, D, D, (bf16*)(ws + WS_WBA), (size_t)D * D, D, 2);
    conv_T<0>(F, a.in[8], (size_t)ATW * D, ATW, D, (bf16*)(ws + WS_WBB), (size_t)D * ATW, D, 2);
    conv_T<0>(F, a.in[9], (size_t)D * D, D, D, (bf16*)(ws + WS_WO), (size_t)D * D, D, 2);
    conv_T<0>(F, a.in[12], (size_t)D * NE, D, NE, (bf16*)(ws + WS_RW), (size_t)NE * D, NE, 2);
    for (int l = 0; l < DEPTH; ++l) {
        conv_T<2>(F, a.in[14] + (size_t)l * NE * D * 512, (size_t)D * 512, D, 512, (bf16*)(ws + WS_WGU) + (size_t)l * NEX * 512 * D, (size_t)512 * D, 512, NE);
        conv_T<0>(F, a.in[15] + (size_t)l * NE * EDIM * D, (size_t)EDIM * D, EDIM, D, (bf16*)(ws + WS_WD) + (size_t)l * NEX * D * EDIM, (size_t)D * EDIM, D, NE);
    }
    conv_T<2>(F, a.in[16], (size_t)D * 512, D, 512, (bf16*)(ws + WS_WGU) + (size_t)NE * 512 * D, (size_t)NEX * 512 * D, 512, 2);
    conv_T<0>(F, a.in[17], (size_t)EDIM * D, EDIM, D, (bf16*)(ws + WS_WD) + (size_t)NE * D * EDIM, (size_t)NEX * D * EDIM, D, 2);
    const float* x = a.in[0]; bf16* xb = (bf16*)(ws + WS_XB);
    const size_t n8 = (size_t)M * D / 8;
    for (size_t i = (size_t)F.bid * NTHR + F.tid; i < n8; i += (size_t)F.G * NTHR) {
        const f32x4 v0 = *(const f32x4*)(x + i * 8), v1 = *(const f32x4*)(x + i * 8 + 4);
        v4u o; o.x = pk2(v0.x, v0.y); o.y = pk2(v0.z, v0.w); o.z = pk2(v1.x, v1.y); o.w = pk2(v1.z, v1.w);
        *(v4u*)(xb + i * 8) = o;
    }
}

template <class Epi>
__device__ __forceinline__ void slow_gemm(const Frame& F, const bf16* A, int lda, const bf16* Bt, int K, int Mrows, int N, const Epi& epi) {
    float* As = (float*)F.lds;
    float* Bs = (float*)(F.lds + 32 * 68 * 4);
    const int tid = F.tid, tx = tid & 31, ty = tid >> 5;
    const int ntn = N / 128, ntiles = (Mrows / 64) * ntn;
    for (int tile = F.bid; tile < ntiles; tile += F.G) {
        const int tm = tile / ntn, tn = tile - tm * ntn, m0 = tm * 64, n0 = tn * 128;
        float acc[4][4];
#pragma unroll
        for (int i = 0; i < 4; ++i)
#pragma unroll
            for (int j = 0; j < 4; ++j) acc[i][j] = 0.f;
        for (int k0 = 0; k0 < K; k0 += 32) {
            { const int r = tid >> 3, kq = (tid & 7) * 4; const v2u w = *(const v2u*)(A + (size_t)(m0 + r) * lda + k0 + kq);
              As[(kq + 0) * 68 + r] = bflo(w.x); As[(kq + 1) * 68 + r] = bfhi(w.x); As[(kq + 2) * 68 + r] = bflo(w.y); As[(kq + 3) * 68 + r] = bfhi(w.y); }
#pragma unroll
            for (int p = 0; p < 2; ++p) { const int r = (tid >> 3) + 64 * p, kq = (tid & 7) * 4; const v2u w = *(const v2u*)(Bt + (size_t)(n0 + r) * K + k0 + kq);
              Bs[(kq + 0) * 132 + r] = bflo(w.x); Bs[(kq + 1) * 132 + r] = bfhi(w.x); Bs[(kq + 2) * 132 + r] = bflo(w.y); Bs[(kq + 3) * 132 + r] = bfhi(w.y); }
            __syncthreads();
#pragma unroll 8
            for (int k = 0; k < 32; ++k) {
                const f32x4 av = *(const f32x4*)(As + k * 68 + ty * 4), bv = *(const f32x4*)(Bs + k * 132 + tx * 4);
#pragma unroll
                for (int i = 0; i < 4; ++i)
#pragma unroll
                    for (int j = 0; j < 4; ++j) acc[i][j] = fmaf(av[i], bv[j], acc[i][j]);
            }
            __syncthreads();
        }
#pragma unroll
        for (int i = 0; i < 4; ++i) epi(m0 + ty * 4 + i, n0 + tx * 4, (f32x4){acc[i][0], acc[i][1], acc[i][2], acc[i][3]});
    }
}
struct EpiStoreBf16 { bf16* C; int ldc;
    __device__ __forceinline__ void operator()(int r, int c, f32x4 v) const { v2u o; o.x = pk2(v.x, v.y); o.y = pk2(v.z, v.w); *(v2u*)(C + (size_t)r * ldc + c) = o; } };
struct EpiStoreF32 { float* C; int ldc;
    __device__ __forceinline__ void operator()(int r, int c, f32x4 v) const { *(f32x4*)(C + (size_t)r * ldc + c) = v; } };
struct EpiGateA { float* tmp; const bf16* proj;
    __device__ __forceinline__ void operator()(int r, int c, f32x4 v) const { const v2u g = *(const v2u*)(proj + (size_t)r * NP + PC_GA + c);
        f32x4 o; o.x = sigmoidf_(bflo(g.x)) * v.x; o.y = sigmoidf_(bfhi(g.x)) * v.y; o.z = sigmoidf_(bflo(g.y)) * v.z; o.w = sigmoidf_(bfhi(g.y)) * v.w; *(f32x4*)(tmp + (size_t)r * D + c) = o; } };
struct EpiGateB { const float* tmp; const bf16* proj; bf16* mixin;
    __device__ __forceinline__ void operator()(int r, int c, f32x4 v) const { const v2u g = *(const v2u*)(proj + (size_t)r * NP + PC_GB + c); const f32x4 t = *(const f32x4*)(tmp + (size_t)r * D + c);
        v2u o; o.x = pk2(t.x + sigmoidf_(bflo(g.x)) * v.x, t.y + sigmoidf_(bfhi(g.x)) * v.y); o.y = pk2(t.z + sigmoidf_(bflo(g.y)) * v.z, t.w + sigmoidf_(bfhi(g.y)) * v.w); *(v2u*)(mixin + (size_t)r * D + c) = o; } };

__device__ __forceinline__ void phase_dnpre_slow(const Frame& F, const Args& a, int l) {
    const bf16* proj = (const bf16*)(F.ws + WS_PROJ);
    float* qkv = (float*)(F.ws + WS_SCR);
    const float* cw = a.in[2] + (size_t)l * 4 * 3072;
    const int gw = F.bid * NWAVES + F.wave, NGW = F.G * NWAVES, lane = F.lane;
    for (int it = gw; it < M * 24; it += NGW) {
        const int m = it / 24, r = it - m * 24, sec = r >> 3, h = r & 7, t = m & (SEQ - 1);
        const int c0 = sec * 1024 + h * 128 + 2 * lane;
        float v0 = 0.f, v1 = 0.f;
#pragma unroll
        for (int i = 0; i < 4; ++i) { const int tt = t - 3 + i; if (tt >= 0) { const unsigned w = *(const unsigned*)(proj + (size_t)(m - 3 + i) * NP + c0);
            v0 = fmaf(bflo(w), cw[i * 3072 + c0], v0); v1 = fmaf(bfhi(w), cw[i * 3072 + c0 + 1], v1); } }
        v0 = siluf_(v0); v1 = siluf_(v1);
        if (sec < 2) { const float ss = wave_sum(v0 * v0 + v1 * v1); float sc = 1.f / sqrtf(ss + L2_EPS); if (sec == 0) sc *= 0.08838834764831845f; v0 *= sc; v1 *= sc; }
        float* o = qkv + (size_t)sec * M * D + (size_t)m * D + h * 128 + 2 * lane; o[0] = v0; o[1] = v1;
    }
    float* bg = (float*)(F.ws + WS_BG);
    const float* alog = a.in[3] + l * 8; const float* dtb = a.in[4] + l * 8;
    for (int i = F.bid * NTHR + F.tid; i < M * 8; i += F.G * NTHR) {
        const int m = i >> 3, h = i & 7;
        const float b = bf2f(proj[(size_t)m * NP + PC_DB + h]), av = bf2f(proj[(size_t)m * NP + PC_DA + h]);
        const float xx = av + dtb[h]; const float sp = xx > 20.f ? xx : log1pf(__expf(xx));
        bg[i] = sigmoidf_(b); bg[(size_t)M * 8 + i] = -__expf(alog[h]) * sp;
    }
}
__device__ __forceinline__ void phase_dnrec_slow(const Frame& F) {
    if (F.bid >= BATCH * DNH) return;
    const int b = F.bid >> 3, h = F.bid & 7, tid = F.tid, j = tid >> 2, p = tid & 3;
    const float* qf = (const float*)(F.ws + WS_SCR); const float* kf = qf + (size_t)M * D; const float* vf = kf + (size_t)M * D; float* of = (float*)(vf + (size_t)M * D);
    const float* bg = (const float*)(F.ws + WS_BG);
    float* Lk = (float*)F.lds; float* Lq = Lk + 16 * 128; float* Lv = Lq + 16 * 128; float* La = Lv + 16 * 128; float* Lb = La + 16;
    float S[32];
#pragma unroll
    for (int i = 0; i < 32; ++i) S[i] = 0.f;
    for (int t0 = 0; t0 < SEQ; t0 += 16) {
        __syncthreads();
        for (int i = tid; i < 16 * 128; i += NTHR) { const int tt = i >> 7, c = i & 127; const size_t off = (size_t)(b * SEQ + t0 + tt) * D + h * 128 + c;
            Lk[i] = kf[off]; Lq[i] = qf[off]; Lv[i] = vf[off]; }
        if (tid < 16) { const size_t mi = (size_t)(b * SEQ + t0 + tid) * 8 + h; La[tid] = __expf(bg[(size_t)M * 8 + mi]); Lb[tid] = bg[mi]; }
        __syncthreads();
        for (int tt = 0; tt < 16; ++tt) {
            const float av = La[tt], bv = Lb[tt]; const float* kk = Lk + tt * 128 + 32 * p; const float* qq = Lq + tt * 128 + 32 * p;
            float dot = 0.f;
#pragma unroll
            for (int i = 0; i < 32; ++i) { S[i] *= av; dot = fmaf(kk[i], S[i], dot); }
            dot += __shfl_xor(dot, 1); dot += __shfl_xor(dot, 2);
            const float vn = bv * (Lv[tt * 128 + j] - dot);
            float od = 0.f;
#pragma unroll
            for (int i = 0; i < 32; ++i) { S[i] = fmaf(kk[i], vn, S[i]); od = fmaf(qq[i], S[i], od); }
            od += __shfl_xor(od, 1); od += __shfl_xor(od, 2);
            if (p == 0) of[(size_t)(b * SEQ + t0 + tt) * D + h * 128 + j] = od;
        }
    }
}
__device__ __forceinline__ void phase_dngate_slow(const Frame& F, const Args& a, int l) {
    const bf16* proj = (const bf16*)(F.ws + WS_PROJ); const float* of = (const float*)(F.ws + WS_SCR) + (size_t)3 * M * D; bf16* dno = (bf16*)(F.ws + WS_DNO);
    const float* nw = a.in[5] + l * 128;
    const int gw = F.bid * NWAVES + F.wave, NGW = F.G * NWAVES, lane = F.lane;
    for (int it = gw; it < M * 8; it += NGW) {
        const int m = it >> 3, h = it & 7; const size_t off = (size_t)m * D + h * 128 + 2 * lane;
        const float o0 = of[off], o1 = of[off + 1];
        const float ms = wave_sum(o0 * o0 + o1 * o1) * (1.f / 128.f); const float r = 1.f / sqrtf(ms + RMS_EPS);
        const unsigned z = *(const unsigned*)(proj + (size_t)m * NP + PC_DZ + h * 128 + 2 * lane);
        *(unsigned*)(dno + off) = pk2(o0 * r * nw[2 * lane] * siluf_(bflo(z)), o1 * r * nw[2 * lane + 1] * siluf_(bfhi(z)));
    }
}

__device__ __forceinline__ void phase_att_slow(const Frame& F, const Args& a, int l) {
    const bf16* proj = (const bf16*)(F.ws + WS_PROJ); bf16* ato = (bf16*)(F.ws + WS_ATO);
    const float* rel = a.in[6] + (size_t)l * ATH * 513;
    const int gw = F.bid * NWAVES + F.wave, NGW = F.G * NWAVES, lane = F.lane;
    for (int it = gw; it < BATCH * ATH * NCH; it += NGW) {
        const int n = it & 63, h = (it >> 6) & 7, b = it >> 9;
        const size_t mq = (size_t)(b * SEQ + n * 64 + lane);
        float q[64], o[64];
#pragma unroll
        for (int d8 = 0; d8 < 8; ++d8) { const v4u w = *(const v4u*)(proj + mq * NP + PC_AQ + h * 64 + d8 * 8);
            q[d8 * 8 + 0] = bflo(w.x); q[d8 * 8 + 1] = bfhi(w.x); q[d8 * 8 + 2] = bflo(w.y); q[d8 * 8 + 3] = bfhi(w.y);
            q[d8 * 8 + 4] = bflo(w.z); q[d8 * 8 + 5] = bfhi(w.z); q[d8 * 8 + 6] = bflo(w.w); q[d8 * 8 + 7] = bfhi(w.w); }
#pragma unroll
        for (int d = 0; d < 64; ++d) o[d] = 0.f;
        float mx = -1e30f, den = 0.f;
        const int c_lo = n - 8 < 0 ? 0 : n - 8;
        for (int c = c_lo; c <= n; ++c) {
            for (int kk = 0; kk < 64; ++kk) {
                const size_t mk = (size_t)(b * SEQ + c * 64 + kk);
                const bf16* kr = proj + mk * NP + PC_AK + h * 64; const bf16* vr = proj + mk * NP + PC_AV + h * 64;
                float s = 0.f;
#pragma unroll
                for (int d8 = 0; d8 < 8; ++d8) { const v4u w = *(const v4u*)(kr + d8 * 8);
                    s = fmaf(q[d8 * 8 + 0], bflo(w.x), s); s = fmaf(q[d8 * 8 + 1], bfhi(w.x), s); s = fmaf(q[d8 * 8 + 2], bflo(w.y), s); s = fmaf(q[d8 * 8 + 3], bfhi(w.y), s);
                    s = fmaf(q[d8 * 8 + 4], bflo(w.z), s); s = fmaf(q[d8 * 8 + 5], bfhi(w.z), s); s = fmaf(q[d8 * 8 + 6], bflo(w.w), s); s = fmaf(q[d8 * 8 + 7], bfhi(w.w), s); }
                int ri = (c - n) * 64 + kk - lane; ri = ri < -256 ? -256 : ri; ri += 256;
                s = s * 0.125f + rel[h * 513 + ri];
                const float mn = fmaxf(mx, s), corr = __expf(mx - mn), pp = __expf(s - mn);
                den = den * corr + pp; mx = mn;
#pragma unroll
                for (int d8 = 0; d8 < 8; ++d8) { const v4u w = *(const v4u*)(vr + d8 * 8);
                    o[d8 * 8 + 0] = fmaf(pp, bflo(w.x), o[d8 * 8 + 0] * corr); o[d8 * 8 + 1] = fmaf(pp, bfhi(w.x), o[d8 * 8 + 1] * corr);
                    o[d8 * 8 + 2] = fmaf(pp, bflo(w.y), o[d8 * 8 + 2] * corr); o[d8 * 8 + 3] = fmaf(pp, bfhi(w.y), o[d8 * 8 + 3] * corr);
                    o[d8 * 8 + 4] = fmaf(pp, bflo(w.z), o[d8 * 8 + 4] * corr); o[d8 * 8 + 5] = fmaf(pp, bfhi(w.z), o[d8 * 8 + 5] * corr);
                    o[d8 * 8 + 6] = fmaf(pp, bflo(w.w), o[d8 * 8 + 6] * corr); o[d8 * 8 + 7] = fmaf(pp, bfhi(w.w), o[d8 * 8 + 7] * corr); }
            }
        }
        const float inv = 1.f / den;
#pragma unroll
        for (int d8 = 0; d8 < 8; ++d8) { v4u w; w.x = pk2(o[d8 * 8 + 0] * inv, o[d8 * 8 + 1] * inv); w.y = pk2(o[d8 * 8 + 2] * inv, o[d8 * 8 + 3] * inv);
            w.z = pk2(o[d8 * 8 + 4] * inv, o[d8 * 8 + 5] * inv); w.w = pk2(o[d8 * 8 + 6] * inv, o[d8 * 8 + 7] * inv);
            *(v4u*)(ato + mq * ATW + h * 64 + d8 * 8) = w; }
    }
}

__device__ __forceinline__ void phase_ln_slow(const Frame& F, const float* xin, const float* add, const float* g, const float* bta, float* outf, bf16* outb) {
    const int gw = F.bid * NWAVES + F.wave, NGW = F.G * NWAVES, lane = F.lane;
    for (int m = gw; m < M; m += NGW) {
        f32x4 v[4]; float s = 0.f;
#pragma unroll
        for (int jj = 0; jj < 4; ++jj) { const size_t off = (size_t)m * D + 256 * jj + 4 * lane; const f32x4 xv = *(const f32x4*)(xin + off), av = *(const f32x4*)(add + off);
            v[jj] = xv * ALPHA + av; s += (v[jj].x + v[jj].y) + (v[jj].z + v[jj].w); }
        const float mean = wave_sum(s) * (1.f / D); float s2 = 0.f;
#pragma unroll
        for (int jj = 0; jj < 4; ++jj) { v[jj] = v[jj] - mean; s2 += (v[jj].x * v[jj].x + v[jj].y * v[jj].y) + (v[jj].z * v[jj].z + v[jj].w * v[jj].w); }
        const float rstd = 1.f / sqrtf(wave_sum(s2) * (1.f / D) + LN_EPS);
#pragma unroll
        for (int jj = 0; jj < 4; ++jj) { const int c = 256 * jj + 4 * lane; const f32x4 gv = *(const f32x4*)(g + c), bv = *(const f32x4*)(bta + c);
            const f32x4 y = v[jj] * rstd * gv + bv; *(f32x4*)(outf + (size_t)m * D + c) = y;
            v2u o; o.x = pk2(y.x, y.y); o.y = pk2(y.z, y.w); *(v2u*)(outb + (size_t)m * D + c) = o; }
    }
}

__device__ __forceinline__ void phase_router_slow(const Frame& F, const Args& a, int l) {
    const float* x1 = (const float*)(F.ws + WS_X1F); const float* rw = a.in[12] + (size_t)l * D * NE; const float* rb = a.in[13] + l * NE;
    int* sel = (int*)(F.ws + WS_SEL); float* wsel = (float*)(F.ws + WS_SEL) + (size_t)M * 8;
    const int gw = F.bid * NWAVES + F.wave, NGW = F.G * NWAVES, lane = F.lane;
    for (int m = gw; m < M; m += NGW) {
        float acc = 0.f; const float* xr = x1 + (size_t)m * D;
        for (int i = 0; i < D; i += 4) { const f32x4 xv = *(const f32x4*)(xr + i);
            acc = fmaf(xv.x, rw[(i + 0) * NE + lane], acc); acc = fmaf(xv.y, rw[(i + 1) * NE + lane], acc); acc = fmaf(xv.z, rw[(i + 2) * NE + lane], acc); acc = fmaf(xv.w, rw[(i + 3) * NE + lane], acc); }
        const float sc = 1.f / (1.f + expf(-acc)); float key = sc + rb[lane];
        float mysel_w = 0.f; int mysel = 0; float den = 0.f;
#pragma unroll
        for (int k = 0; k < TOPK; ++k) {
            const float mv = wave_max(key);
            const unsigned long long bal = __ballot(key == mv);
            const int win = __ffsll((long long)bal) - 1;
            const float ws = __shfl(sc, win);
            den += ws;
            if (lane == k) { mysel = win; mysel_w = ws; }
            if (lane == win) key = -1e30f;
        }
        if (lane < TOPK) { sel[(size_t)m * 8 + lane] = mysel; wsel[(size_t)m * 8 + lane] = mysel_w / den * ROUTED_SCALE; }
    }
}

__device__ __forceinline__ void phase_moe_slow(const Frame& F, int l) {
    const bf16* x1b = (const bf16*)(F.ws + WS_X1B); const bf16* wgu = (const bf16*)(F.ws + WS_WGU) + (size_t)l * NEX * 512 * D; const bf16* wd = (const bf16*)(F.ws + WS_WD) + (size_t)l * NEX * D * EDIM;
    const int* sel = (const int*)(F.ws + WS_SEL); const float* wsel = (const float*)(F.ws + WS_SEL) + (size_t)M * 8;
    float* ffn = (float*)(F.ws + WS_SCR) + (size_t)2 * M * D;
    float* Lgu = (float*)F.lds; float* Lh = Lgu + 512; float* Lo = Lh + 256;
    const int lane = F.lane, wave = F.wave, tid = F.tid;
    for (int m = F.bid; m < M; m += F.G) {
        float xv[16];
        { const v4u w0 = *(const v4u*)(x1b + (size_t)m * D + lane * 8), w1 = *(const v4u*)(x1b + (size_t)m * D + 512 + lane * 8);
          xv[0] = bflo(w0.x); xv[1] = bfhi(w0.x); xv[2] = bflo(w0.y); xv[3] = bfhi(w0.y); xv[4] = bflo(w0.z); xv[5] = bfhi(w0.z); xv[6] = bflo(w0.w); xv[7] = bfhi(w0.w);
          xv[8] = bflo(w1.x); xv[9] = bfhi(w1.x); xv[10] = bflo(w1.y); xv[11] = bfhi(w1.y); xv[12] = bflo(w1.z); xv[13] = bfhi(w1.z); xv[14] = bflo(w1.w); xv[15] = bfhi(w1.w); }
        for (int i = tid; i < D; i += NTHR) Lo[i] = 0.f;
        for (int k = 0; k < TOPK + 1; ++k) {
            const int e = k < TOPK ? sel[(size_t)m * 8 + k] : NE; const float wt = k < TOPK ? wsel[(size_t)m * 8 + k] : 1.f;
            const bf16* W1 = wgu + (size_t)e * 512 * D; const bf16* W2 = wd + (size_t)e * D * EDIM;
            __syncthreads();
            for (int rr = 0; rr < 64; ++rr) { const int r = wave * 64 + rr;
                const v4u w0 = *(const v4u*)(W1 + (size_t)r * D + lane * 8), w1 = *(const v4u*)(W1 + (size_t)r * D + 512 + lane * 8);
                float s = xv[0] * bflo(w0.x) + xv[1] * bfhi(w0.x) + xv[2] * bflo(w0.y) + xv[3] * bfhi(w0.y) + xv[4] * bflo(w0.z) + xv[5] * bfhi(w0.z) + xv[6] * bflo(w0.w) + xv[7] * bfhi(w0.w)
                        + xv[8] * bflo(w1.x) + xv[9] * bfhi(w1.x) + xv[10] * bflo(w1.y) + xv[11] * bfhi(w1.y) + xv[12] * bflo(w1.z) + xv[13] * bfhi(w1.z) + xv[14] * bflo(w1.w) + xv[15] * bfhi(w1.w);
                s = wave_sum(s); if (lane == 0) Lgu[r] = s; }
            __syncthreads();
            if (tid < 256) { const int jj = tid; const float gt = Lgu[(jj >> 7) * 256 + (jj & 127)], up = Lgu[(jj >> 7) * 256 + 128 + (jj & 127)]; Lh[jj] = siluf_(gt) * up; }
            __syncthreads();
            const float h0 = Lh[4 * lane], h1 = Lh[4 * lane + 1], h2 = Lh[4 * lane + 2], h3 = Lh[4 * lane + 3];
            for (int rr = 0; rr < 128; ++rr) { const int r = wave * 128 + rr; const v2u w = *(const v2u*)(W2 + (size_t)r * EDIM + 4 * lane);
                float s = h0 * bflo(w.x) + h1 * bfhi(w.x) + h2 * bflo(w.y) + h3 * bfhi(w.y); s = wave_sum(s); if (lane == 0) Lo[r] += wt * s; }
        }
        __syncthreads();
        for (int i = tid; i < D; i += NTHR) ffn[(size_t)m * D + i] = Lo[i];
        __syncthreads();
    }
}

__global__ void __launch_bounds__(NTHR, 2) mk_fwd(Args args) {
    extern __shared__ __attribute__((aligned(16))) unsigned char lds[];
    Frame F; F.lds = lds; F.tid = threadIdx.x; F.lane = F.tid & 63; F.wave = __builtin_amdgcn_readfirstlane(F.tid >> 6); F.G = gridDim.x; F.bid = blockIdx.x; F.ws = args.ws;
    volatile LAS unsigned* MISC = (volatile LAS unsigned*)((LAS unsigned char*)lds + MISC_OFF);
    if (F.tid < 64) MISC[F.tid] = 0u;
    __syncthreads();
    XcdBarrier bar = xcd_barrier_post((unsigned*)(args.ws + WS_CTL) + CW_BAR, MISC + 8);
#define GRID_BAR() xcd_barrier(bar)
    unsigned char* ws = args.ws;
    phase_convert(F, args); GRID_BAR();
    for (int l = 0; l < DEPTH; ++l) {
        const float* xres = l == 0 ? args.in[0] : (const float*)(ws + WS_XF);
        const bf16* xb = (const bf16*)(ws + WS_XB);
        bf16* proj = (bf16*)(ws + WS_PROJ);
        { EpiStoreBf16 E{proj, NP}; slow_gemm(F, xb, D, (const bf16*)(ws + WS_WIN) + (size_t)l * NP * D, D, M, NP, E); }
        GRID_BAR();
        phase_dnpre_slow(F, args, l); GRID_BAR();
        phase_dnrec_slow(F); phase_att_slow(F, args, l); GRID_BAR();
        phase_dngate_slow(F, args, l); GRID_BAR();
        { float* tmp = (float*)(ws + WS_SCR);
          EpiGateA EA{tmp, proj}; slow_gemm(F, (const bf16*)(ws + WS_DNO), D, (const bf16*)(ws + WS_WBA) + (size_t)l * D * D, D, M, D, EA);
          EpiGateB EB{tmp, proj, (bf16*)(ws + WS_MIXIN)}; slow_gemm(F, (const bf16*)(ws + WS_ATO), ATW, (const bf16*)(ws + WS_WBB) + (size_t)l * D * ATW, ATW, M, D, EB); }
        GRID_BAR();
        { EpiStoreF32 E{(float*)(ws + WS_SCR) + (size_t)M * D, D}; slow_gemm(F, (const bf16*)(ws + WS_MIXIN), D, (const bf16*)(ws + WS_WO) + (size_t)l * D * D, D, M, D, E); }
        GRID_BAR();
        phase_ln_slow(F, xres, (const float*)(ws + WS_SCR) + (size_t)M * D, args.in[10] + l * D, args.in[11] + l * D, (float*)(ws + WS_X1F), (bf16*)(ws + WS_X1B));
        GRID_BAR();
        phase_router_slow(F, args, l); GRID_BAR();
        phase_moe_slow(F, l); GRID_BAR();
        phase_ln_slow(F, (const float*)(ws + WS_X1F), (const float*)(ws + WS_SCR) + (size_t)2 * M * D, args.in[18] + l * D, args.in[19] + l * D,
                      l == DEPTH - 1 ? args.out : (float*)(ws + WS_XF), (bf16*)(ws + WS_XB));
        if (l != DEPTH - 1) GRID_BAR();
    }
}

extern "C" void kernel_launch(void* const* d_in, const int* in_sizes, int n_in, void* d_out, int out_size, void* d_ws, size_t ws_size, hipStream_t stream) {
    static int grid = 0;
    if (grid == 0) {
        if (n_in != 20 || out_size != M * D || ws_size < WS_END) { fprintf(stderr, "kernel_launch: unexpected shapes (n_in %d out %d ws %zu)\n", n_in, out_size, ws_size); grid = -1; return; }
        int dev = 0, cus = 0, per_cu = 0;
        if (hipGetDevice(&dev) != hipSuccess || hipDeviceGetAttribute(&cus, hipDeviceAttributeMultiprocessorCount, dev) != hipSuccess) { grid = -1; return; }
        if (hipFuncSetAttribute((const void*)mk_fwd, hipFuncAttributeMaxDynamicSharedMemorySize, LDS_BYTES) != hipSuccess) { fprintf(stderr, "kernel_launch: hipFuncSetAttribute failed\n"); grid = -1; return; }
        if (hipOccupancyMaxActiveBlocksPerMultiprocessor(&per_cu, (const void*)mk_fwd, NTHR, LDS_BYTES) != hipSuccess || per_cu < 1) { fprintf(stderr, "kernel_launch: occupancy query says %d\n", per_cu); (void)hipGetLastError(); grid = -1; return; }
        grid = cus;
    }
    if (grid < 0) return;
    (void)hipMemsetAsync((char*)d_ws + WS_CTL, 0, CTL_ZERO_BYTES, stream);
    Args a{};
    for (int i = 0; i < 20; ++i) a.in[i] = (const float*)d_in[i];
    a.out = (float*)d_out; a.ws = (unsigned char*)d_ws;
    hipLaunchKernelGGL(mk_fwd, dim3(grid), dim3(NTHR), LDS_BYTES, stream, a);
}
```
